# Optimizing an MI355X kernel written in HIP

```python
import jax, jax.numpy as jnp
from jax import lax
import numpy as np

D_MODEL = 2048
BATCH = 16
SEQ = 256
DEPTH = 2
DEC_BATCH = 4
DEC_SEQ = 1024
PAST_LEN = 512

GRID_W = 64
N_MIXERS = 2
N_ATTN_LAYERS = (DEPTH + 1) // 2
N_LRU_LAYERS = DEPTH // 2
HEAD_DIM = 128
N_HEADS = D_MODEL // HEAD_DIM
N_KV_HEADS = N_HEADS // 4
Q_PER_KV = N_HEADS // N_KV_HEADS
ATTN_WIDTH = N_HEADS * HEAD_DIM
KV_WIDTH = N_KV_HEADS * HEAD_DIM
AXIS_DIM = HEAD_DIM // 2
ROPE_THETA = 10000.0
Q_BLOCK = 128
LRU_WIDTH = D_MODEL
LRU_BLOCKS = 8
LRU_BLOCK_DIM = LRU_WIDTH // LRU_BLOCKS
CONV_WIDTH = 4
CONV_LEFT = (CONV_WIDTH - 1) // 2
CONV_RIGHT = CONV_WIDTH - 1 - CONV_LEFT
RG_C = 8.0
EPS = 1e-6

kernel_name = 'hybrid_dit_gqa_rglru_step'

F32 = jnp.float32


def rms_norm(x, g):
    xf = x.astype(F32)
    y = xf * lax.rsqrt(jnp.mean(xf * xf, axis=-1, keepdims=True) + EPS)
    return (y * g.astype(F32)).astype(x.dtype)


def adaln(cond, w_mod, b_mod):
    m = jax.nn.silu(cond) @ w_mod + b_mod
    shift, scale, gate = jnp.split(m[:, None, :], 3, axis=-1)
    return shift, scale, gate


def axial_rope_tables(n):
    rows = n // GRID_W
    row = jnp.repeat(jnp.arange(rows, dtype=F32), GRID_W)
    col = jnp.tile(jnp.arange(GRID_W, dtype=F32), rows)
    inv = ROPE_THETA ** (-jnp.arange(0, AXIS_DIM, 2, dtype=F32) / AXIS_DIM)
    ar = row[:, None] * inv
    ac = col[:, None] * inv
    ang = jnp.concatenate([ar, ar, ac, ac], axis=-1)
    return jnp.cos(ang), jnp.sin(ang)


def rotate_half(u):
    h = u.shape[-1] // 2
    return jnp.concatenate([-u[..., h:], u[..., :h]], axis=-1)


def apply_axial_rope(x, cos, sin):
    rot = jnp.concatenate([rotate_half(x[..., :AXIS_DIM]), rotate_half(x[..., AXIS_DIM:])], axis=-1)
    out = x.astype(F32) * cos[None, :, None, :] + rot.astype(F32) * sin[None, :, None, :]
    return out.astype(x.dtype)


def blocked_attention(q, k, v):
    b, nq = q.shape[0], q.shape[1]
    nb = nq // Q_BLOCK
    qb = q.reshape(b, nb, Q_BLOCK, N_KV_HEADS, Q_PER_KV, HEAD_DIM).swapaxes(0, 1)
    scale = HEAD_DIM ** -0.5

    def one_block(qblk):
        s = jnp.einsum('bqkgd,bskd->bkgqs', qblk, k, preferred_element_type=F32) * scale
        p = jax.nn.softmax(s, axis=-1).astype(v.dtype)
        return jnp.einsum('bkgqs,bskd->bqkgd', p, v)

    o = lax.map(one_block, qb)
    return o.swapaxes(0, 1).reshape(b, nq, ATTN_WIDTH)


def attn_in(h, w_in, q_norm, k_norm):
    b, n, _ = h.shape
    p = h @ w_in
    q, k, v, g = jnp.split(p, [ATTN_WIDTH, ATTN_WIDTH + KV_WIDTH, ATTN_WIDTH + 2 * KV_WIDTH], axis=-1)
    q = rms_norm(q.reshape(b, n, N_HEADS, HEAD_DIM), q_norm)
    k = rms_norm(k.reshape(b, n, N_KV_HEADS, HEAD_DIM), k_norm)
    v = v.reshape(b, n, N_KV_HEADS, HEAD_DIM)
    return q, k, v, g


def attn_context(h, w_in, q_norm, k_norm, w_out):
    q, k, v, g = attn_in(h, w_in, q_norm, k_norm)
    o = blocked_attention(q, k, v)
    return (o * jax.nn.silu(g)) @ w_out, k, v


def attn_latent(h, ck, cv, w_in, q_norm, k_norm, w_out):
    q, k, v, g = attn_in(h, w_in, q_norm, k_norm)
    cos, sin = axial_rope_tables(h.shape[1])
    q = apply_axial_rope(q, cos, sin)
    k = apply_axial_rope(k, cos, sin)
    keys = jnp.concatenate([ck.astype(k.dtype), k], axis=1)
    vals = jnp.concatenate([cv.astype(v.dtype), v], axis=1)
    o = blocked_attention(q, keys, vals)
    return (o * jax.nn.silu(g)) @ w_out


def centred_depthwise_conv(x, w, b):
    n = x.shape[1]
    xp = jnp.pad(x, ((0, 0), (CONV_LEFT, CONV_RIGHT), (0, 0)))
    return sum((xp[:, j:j + n] * w[j] for j in range(CONV_WIDTH)), b)


def block_diag_linear(x, w, b):
    bsz, n, _ = x.shape
    y = jnp.einsum('bnhi,hij->bnhj', x.reshape(bsz, n, LRU_BLOCKS, LRU_BLOCK_DIM), w)
    return y.reshape(bsz, n, LRU_WIDTH) + b


def rglru_coeffs(x, w_a, b_a, w_x, b_x, lam):
    r = jax.nn.sigmoid(block_diag_linear(x, w_a, b_a).astype(F32))
    i = jax.nn.sigmoid(block_diag_linear(x, w_x, b_x).astype(F32))
    log_a = RG_C * r * jax.nn.log_sigmoid(lam.astype(F32))
    a = jnp.exp(log_a)
    mult = jnp.sqrt(-jnp.expm1(2.0 * log_a))
    return a, mult * i * x.astype(F32)


def _combine(e1, e2):
    a1, b1 = e1
    a2, b2 = e2
    return a1 * a2, a2 * b1 + b2


def linear_scan(a, b, h0, reverse):
    idx = -1 if reverse else 0
    b = b.at[:, idx].add(a[:, idx] * h0)
    _, h = lax.associative_scan(_combine, (a, b), axis=1, reverse=reverse)
    return h


def lru_mixer(h, h0_fwd, h0_bwd, w_in, conv_w, conv_b, w_a, b_a, w_x, b_x, lam, w_out):
    xb, gb = jnp.split(h @ w_in, 2, axis=-1)
    xb = centred_depthwise_conv(xb, conv_w, conv_b)
    hs = []
    finals = []
    for d, (h0, rev) in enumerate(((h0_fwd, False), (h0_bwd, True))):
        a, b = rglru_coeffs(xb, w_a[d], b_a[d], w_x[d], b_x[d], lam[d])
        hd = linear_scan(a, b, h0.astype(F32), rev)
        hs.append(hd)
        finals.append(hd[:, 0] if rev else hd[:, -1])
    y = (hs[0] + hs[1]).astype(h.dtype)
    out = (y * jax.nn.silu(gb)) @ w_out
    return out, jnp.stack(finals, axis=1).astype(h.dtype)


def setup_inputs(seed: int = 0) -> dict:
    key = jax.random.key(seed)
    ks = jax.random.split(key, 24)

    def nrm(k, shape, std):
        return std * jax.random.normal(k, shape, F32)

    a0 = jax.random.uniform(ks[22], (N_LRU_LAYERS, 2, LRU_WIDTH), F32, minval=0.9, maxval=0.999)
    s = a0 ** (1.0 / RG_C)
    lru_lambda = jnp.log(s) - jnp.log1p(-s)
    in_w = ATTN_WIDTH + 2 * KV_WIDTH + ATTN_WIDTH
    return {
        'x_prompt': nrm(ks[0], (BATCH, SEQ, D_MODEL), 1.0),
        'x_sample': nrm(ks[1], (DEC_BATCH, DEC_SEQ, D_MODEL), 1.0),
        'c': nrm(ks[2], (DEC_BATCH, D_MODEL), 1.0),
        'cache_k': nrm(ks[3], (DEC_BATCH, N_ATTN_LAYERS, PAST_LEN, N_KV_HEADS, HEAD_DIM), 1.0),
        'cache_v': nrm(ks[4], (DEC_BATCH, N_ATTN_LAYERS, PAST_LEN, N_KV_HEADS, HEAD_DIM), 1.0),
        'state_lru': nrm(ks[5], (DEC_BATCH, N_LRU_LAYERS, 2, LRU_WIDTH), 0.5),
        'c_ctx': nrm(ks[6], (D_MODEL,), 1.0),
        'w_mod': nrm(ks[7], (DEPTH, D_MODEL, 3 * D_MODEL), 0.5 * D_MODEL ** -0.5),
        'b_mod': nrm(ks[8], (DEPTH, 3 * D_MODEL), 0.01),
        'g_pre': 1.0 + nrm(ks[9], (DEPTH, D_MODEL), 0.05),
        'g_post': 1.0 + nrm(ks[10], (DEPTH, D_MODEL), 0.05),
        'w_in_attn': nrm(ks[11], (N_ATTN_LAYERS, D_MODEL, in_w), D_MODEL ** -0.5),
        'q_norm': 1.0 + nrm(ks[12], (N_ATTN_LAYERS, HEAD_DIM), 0.05),
        'k_norm': 1.0 + nrm(ks[13], (N_ATTN_LAYERS, HEAD_DIM), 0.05),
        'w_out_attn': nrm(ks[14], (N_ATTN_LAYERS, ATTN_WIDTH, D_MODEL), ATTN_WIDTH ** -0.5),
        'w_in_lru': nrm(ks[15], (N_LRU_LAYERS, D_MODEL, 2 * LRU_WIDTH), D_MODEL ** -0.5),
        'conv_w': nrm(ks[16], (N_LRU_LAYERS, CONV_WIDTH, LRU_WIDTH), CONV_WIDTH ** -0.5),
        'conv_b': nrm(ks[17], (N_LRU_LAYERS, LRU_WIDTH), 0.01),
        'w_rg_a': nrm(ks[18], (N_LRU_LAYERS, 2, LRU_BLOCKS, LRU_BLOCK_DIM, LRU_BLOCK_DIM), LRU_BLOCK_DIM ** -0.5),
        'b_rg_a': nrm(ks[19], (N_LRU_LAYERS, 2, LRU_WIDTH), 0.01),
        'w_rg_x': nrm(ks[20], (N_LRU_LAYERS, 2, LRU_BLOCKS, LRU_BLOCK_DIM, LRU_BLOCK_DIM), LRU_BLOCK_DIM ** -0.5),
        'b_rg_x': nrm(ks[21], (N_LRU_LAYERS, 2, LRU_WIDTH), 0.01),
        'lru_lambda': lru_lambda,
        'w_out_lru': nrm(ks[23], (N_LRU_LAYERS, LRU_WIDTH, D_MODEL), LRU_WIDTH ** -0.5),
    }


def reference(x_prompt, x_sample, c, cache_k, cache_v, state_lru, c_ctx, w_mod, b_mod, g_pre, g_post,
              w_in_attn, q_norm, k_norm, w_out_attn, w_in_lru, conv_w, conv_b,
              w_rg_a, b_rg_a, w_rg_x, b_rg_x, lru_lambda, w_out_lru):
    y_p = x_prompt
    y_s = x_sample
    new_k, new_v, new_h = [], [], []
    for l in range(DEPTH):
        j = l // N_MIXERS
        sh_c, sc_c, ga_c = adaln(c_ctx[None, :], w_mod[l], b_mod[l])
        sh_s, sc_s, ga_s = adaln(c, w_mod[l], b_mod[l])
        hp = rms_norm(y_p, g_pre[l]) * (1.0 + sc_c) + sh_c
        hs = rms_norm(y_s, g_pre[l]) * (1.0 + sc_s) + sh_s
        if l % N_MIXERS == 0:
            mp, kc, vc = attn_context(hp, w_in_attn[j], q_norm[j], k_norm[j], w_out_attn[j])
            ms = attn_latent(hs, cache_k[:, j], cache_v[:, j], w_in_attn[j], q_norm[j], k_norm[j], w_out_attn[j])
            new_k.append(kc)
            new_v.append(vc)
        else:
            zeros = jnp.zeros((hp.shape[0], LRU_WIDTH), F32)
            mp, fin = lru_mixer(hp, zeros, zeros, w_in_lru[j], conv_w[j], conv_b[j],
                                w_rg_a[j], b_rg_a[j], w_rg_x[j], b_rg_x[j], lru_lambda[j], w_out_lru[j])
            ms, _ = lru_mixer(hs, state_lru[:, j, 0], state_lru[:, j, 1], w_in_lru[j], conv_w[j], conv_b[j],
                              w_rg_a[j], b_rg_a[j], w_rg_x[j], b_rg_x[j], lru_lambda[j], w_out_lru[j])
            new_h.append(fin)
        y_p = y_p + ga_c * rms_norm(mp, g_post[l])
        y_s = y_s + ga_s * rms_norm(ms, g_post[l])
    new_cache_k = jnp.stack(new_k, axis=1)
    new_cache_v = jnp.stack(new_v, axis=1)
    new_state_lru = jnp.stack(new_h, axis=1)
    return (y_p, y_s, new_cache_k, new_cache_v, new_state_lru)
```

```cpp
#include <hip/hip_runtime.h>
#include <hip/hip_bf16.h>
#include <cstdio>
#include <cstdint>

#ifndef MK_N_LAUNCHES
#define MK_N_LAUNCHES 11
#endif

#define LAS __attribute__((address_space(3)))
#define GAS __attribute__((address_space(1)))
typedef unsigned short bf16_t;
typedef short bf16x8 __attribute__((ext_vector_type(8)));
typedef short s16x4 __attribute__((ext_vector_type(4)));
typedef float f32x4 __attribute__((ext_vector_type(4)));
typedef float f32x2 __attribute__((ext_vector_type(2)));
typedef float f32x16 __attribute__((ext_vector_type(16)));
typedef unsigned u32x4 __attribute__((ext_vector_type(4)));
typedef unsigned u32x2 __attribute__((ext_vector_type(2)));

constexpr int DM = 2048, MTOK = 8192, NPR = 4096;
constexpr int SEQP = 256, SEQS = 1024, PAST = 512, KVW = 512, KSROWS = PAST + SEQS;
constexpr int N1 = 5120, N3 = 4096;
constexpr float EPS = 1e-6f;

constexpr size_t MiB = 1u << 20;
constexpr size_t WS_CTL = 0, CTL_ZERO_BYTES = 128 * 1024;
constexpr size_t WS_MOD = 1 * MiB;
constexpr size_t WS_ROPE = 1 * MiB + 512 * 1024;
constexpr size_t WS_W1T = 2 * MiB;
constexpr size_t WS_W2T = 22 * MiB;
constexpr size_t WS_W3T = 30 * MiB;
constexpr size_t WS_WGT = 46 * MiB;
constexpr size_t WS_W4T = 50 * MiB;
constexpr size_t WS_XN = 64 * MiB;
constexpr size_t WS_Q = 96 * MiB;
constexpr size_t WS_KP = 128 * MiB, WS_VP = 132 * MiB, WS_KS = 136 * MiB, WS_VS = 142 * MiB;
constexpr size_t WS_SG = 148 * MiB;
constexpr size_t WS_AO = 180 * MiB;
constexpr size_t WS_MF = 212 * MiB;
constexpr size_t WS_XC = 276 * MiB;
constexpr size_t WS_END = 308 * MiB;
constexpr int CW_BAR = 4096;

constexpr int RING_BYTES = 131072;
constexpr int MISC_OFF = RING_BYTES;
constexpr int EPI_OFF = RING_BYTES + 512;
constexpr int LDS_BYTES = 147456;

__device__ __forceinline__ unsigned cvt_pk_bf16(float lo, float hi) { unsigned r; asm volatile("v_cvt_pk_bf16_f32 %0, %1, %2" : "=v"(r) : "v"(lo), "v"(hi)); return r; }
__device__ __forceinline__ float bf_lo(unsigned w) { return __uint_as_float(w << 16); }
__device__ __forceinline__ float bf_hi(unsigned w) { return __uint_as_float(w & 0xffff0000u); }
__device__ __forceinline__ float sigmoidf_(float x) { return __builtin_amdgcn_rcpf(1.0f + __expf(-x)); }
__device__ __forceinline__ float siluf_(float x) { return x * sigmoidf_(x); }
#define LDS_WAIT() asm volatile("s_waitcnt lgkmcnt(0)" ::: "memory")
#define VM_WAIT() asm volatile("s_waitcnt vmcnt(0)" ::: "memory")

namespace pg8 {
constexpr int BM = 256, BK = 64, HALF = 128, HTB = HALF * BK * 2, NXCD = 8, WGM = 8;
__host__ __device__ __forceinline__ int lds_byte(int r, int c) { const int st = (r >> 4) * 2 + (c >> 5), rr = r & 15, cc = c & 31, ob = rr * 64 + cc * 2; return st * 1024 + (ob ^ (((ob >> 9) & 1) << 5)); }
__host__ __device__ __forceinline__ void stage_rc(int b, int& R, int& C) { const int st = b / 1024, sb = b % 1024, swz = sb ^ (((sb >> 9) & 1) << 5); R = (st >> 1) * 16 + swz / 64; C = (st & 1) * 32 + (swz % 64) / 2; }

struct Unit { const char* a0; const char* a1; const char* b0; const char* b1; int pm, pn, s, ns, rowf, rowb, bidx, flags; };

struct StaticOrder {
    const char* A; const char* Bt; int lda, K; int nM, nN, nwg, G, c;
    __device__ void init(const void* A_, const void* Bt_, int M, int N, int K_, int lda_, int G_, int c_) { A = (const char*)A_; Bt = (const char*)Bt_; K = K_; lda = lda_; nM = M / BM; nN = N / BM; nwg = nM * nN; G = G_; c = c_; }
    __device__ bool next(int i, Unit& u) const {
        const long L = (long)i * G + c; if (L >= nwg) return false;
        int wgid = (int)L; { const int q = nwg / NXCD, r = nwg % NXCD, xcd = wgid % NXCD, off = wgid / NXCD; wgid = (xcd < r ? xcd * (q + 1) : r * (q + 1) + (xcd - r) * q) + off; }
        const int nig = WGM * nN, gid = wgid / nig, fm = gid * WGM, gsz = (nM - fm) < WGM ? (nM - fm) : WGM;
        u.pm = fm + ((wgid % nig) % gsz); u.pn = (wgid % nig) / gsz;
        u.a0 = A + (size_t)u.pm * BM * lda * 2; u.a1 = u.a0 + (size_t)HALF * lda * 2;
        u.b0 = Bt + (size_t)u.pn * BM * K * 2; u.b1 = u.b0 + (size_t)HALF * K * 2;
        u.s = 0; u.ns = 0; u.rowf = 0; u.rowb = 0; u.bidx = 0; u.flags = 0;
        return true;
    }
};

template <class Epi, class Sched>
__device__ __forceinline__ void gemm_phase(LAS unsigned char* lds, const int K, const int lda, const Sched& S, const Epi& E) {
    const int tid = threadIdx.x, wid = __builtin_amdgcn_readfirstlane(tid >> 6), lane = tid & 63, wr = wid >> 2, wc = wid & 3, fr = lane & 15, fq = lane >> 4;
    const int nt = K / BK;
    unsigned voffA[2], voffB[2];
#pragma unroll
    for (int i = 0; i < 2; ++i) { int R, C; stage_rc(tid * 16 + i * 8192, R, C); voffA[i] = (unsigned)(R * lda + C) * 2u; voffB[i] = (unsigned)(R * K + C) * 2u; }
    const size_t kstep = (size_t)(BK * 2);
    const unsigned ldsw = (unsigned)wid * 1024u;
    const int aoff = lds_byte(wr * 64 + fr, fq * 8), boff = lds_byte(wc * 32 + fr, fq * 8);
#define PG8_SA(b, h) (((b) * 2 + (h)) * HTB)
#define PG8_SB(b, h) ((4 + (b) * 2 + (h)) * HTB)
#define PG8_STAGE(bufoff, gbase, voff) do { _Pragma("unroll") for (int _i = 0; _i < 2; ++_i) \
        __builtin_amdgcn_global_load_lds((const unsigned*)((const char*)(gbase) + (voff)[_i]), (LAS unsigned*)(lds + (bufoff) + ldsw + _i * 8192), 16, 0, 0); } while (0)
#define PG8_LDA(dst, b, h) do { _Pragma("unroll") for (int m = 0; m < 4; ++m) _Pragma("unroll") for (int k = 0; k < 2; ++k) dst[m][k] = *(const LAS bf16x8*)(lds + PG8_SA(b, h) + aoff + m * 2048 + k * 1024); } while (0)
#define PG8_LDB(dst, b, h) do { _Pragma("unroll") for (int n = 0; n < 2; ++n) _Pragma("unroll") for (int k = 0; k < 2; ++k) dst[n][k] = *(const LAS bf16x8*)(lds + PG8_SB(b, h) + boff + n * 2048 + k * 1024); } while (0)
#define PG8_MMA(ai, bj, At, Bt) do { __builtin_amdgcn_s_setprio(1); _Pragma("unroll") for (int m = 0; m < 4; ++m) _Pragma("unroll") for (int n = 0; n < 2; ++n) _Pragma("unroll") for (int k = 0; k < 2; ++k) \
        acc[ai][bj][m][n] = __builtin_amdgcn_mfma_f32_16x16x32_bf16(Bt[n][k], At[m][k], acc[ai][bj][m][n], 0, 0, 0); __builtin_amdgcn_s_setprio(0); } while (0)
#define PG8_WAIT_V(n) asm volatile("s_waitcnt vmcnt(" #n ")" ::: "memory")
#define PG8_WAIT_L(n) asm volatile("s_waitcnt lgkmcnt(" #n ")" ::: "memory")
#define PG8_BAR __builtin_amdgcn_s_barrier()
#define PG8_SCHED __builtin_amdgcn_sched_barrier(0)
    Unit cur, nxt; int ui = 0;
    if (!S.next(0, cur)) return;
    f32x4 acc[2][2][4][2];
#pragma unroll
    for (int a = 0; a < 2; ++a)
#pragma unroll
        for (int b = 0; b < 2; ++b)
#pragma unroll
            for (int m = 0; m < 4; ++m)
#pragma unroll
                for (int n = 0; n < 2; ++n) acc[a][b][m][n] = (f32x4){0.f, 0.f, 0.f, 0.f};
    bf16x8 At[4][2], B0[2][2], B1[2][2];
    const char* cA0 = cur.a0; const char* cA1 = cur.a1; const char* cB0 = cur.b0; const char* cB1 = cur.b1;
    PG8_STAGE(PG8_SB(0, 0), cB0, voffB); PG8_STAGE(PG8_SB(0, 1), cB1, voffB); PG8_STAGE(PG8_SA(0, 0), cA0, voffA); PG8_STAGE(PG8_SA(0, 1), cA1, voffA);
    if (wr == 1) PG8_BAR;
    PG8_WAIT_V(2); PG8_BAR;
    PG8_STAGE(PG8_SB(1, 0), cB0 + kstep, voffB); PG8_STAGE(PG8_SA(1, 0), cA0 + kstep, voffA); PG8_STAGE(PG8_SB(1, 1), cB1 + kstep, voffB);
    PG8_WAIT_V(6); PG8_BAR;
    for (;;) {
        const bool has_next = S.next(ui + 1, nxt);
        const char* nA0 = has_next ? nxt.a0 : cA0; const char* nA1 = has_next ? nxt.a1 : cA1; const char* nB0 = has_next ? nxt.b0 : cB0; const char* nB1 = has_next ? nxt.b1 : cB1;
        for (int t = 0; t < nt; t += 2) {
            const bool last = (t == nt - 2);
            const char* a1h1 = cA1 + (size_t)(t + 1) * kstep;
            const char* a2h0 = last ? nA0 : cA0 + (size_t)(t + 2) * kstep; const char* a2h1 = last ? nA1 : cA1 + (size_t)(t + 2) * kstep;
            const char* b2h0 = last ? nB0 : cB0 + (size_t)(t + 2) * kstep; const char* b2h1 = last ? nB1 : cB1 + (size_t)(t + 2) * kstep;
            const char* a3h0 = a2h0 + kstep; const char* b3h0 = b2h0 + kstep; const char* b3h1 = b2h1 + kstep;
            PG8_LDB(B0, 0, 0); PG8_LDB(B1, 0, 1); PG8_SCHED; PG8_LDA(At, 0, 0); PG8_STAGE(PG8_SA(1, 1), a1h1, voffA);
            PG8_WAIT_V(8); PG8_WAIT_L(0); PG8_BAR; PG8_MMA(0, 0, At, B0); PG8_MMA(0, 1, At, B1); PG8_BAR; PG8_SCHED;
            PG8_LDA(At, 0, 1); PG8_STAGE(PG8_SB(0, 0), b2h0, voffB); PG8_STAGE(PG8_SB(0, 1), b2h1, voffB); PG8_STAGE(PG8_SA(0, 0), a2h0, voffA);
            PG8_WAIT_V(8); PG8_WAIT_L(0); PG8_BAR; PG8_MMA(1, 0, At, B0); PG8_MMA(1, 1, At, B1); PG8_BAR; PG8_SCHED;
            PG8_LDB(B0, 1, 0); PG8_LDB(B1, 1, 1); PG8_SCHED; PG8_LDA(At, 1, 0); PG8_STAGE(PG8_SA(0, 1), a2h1, voffA);
            PG8_WAIT_V(8); PG8_WAIT_L(0); PG8_BAR; PG8_MMA(0, 0, At, B0); PG8_MMA(0, 1, At, B1); PG8_BAR; PG8_SCHED;
            PG8_LDA(At, 1, 1); PG8_STAGE(PG8_SB(1, 0), b3h0, voffB); PG8_STAGE(PG8_SB(1, 1), b3h1, voffB); PG8_STAGE(PG8_SA(1, 0), a3h0, voffA);
            PG8_WAIT_V(8); PG8_WAIT_L(0); PG8_BAR; PG8_MMA(1, 0, At, B0); PG8_MMA(1, 1, At, B1); PG8_BAR; PG8_SCHED;
        }
        if (wr == 0) PG8_BAR;
        { int fre = fr, fqe = fq; asm volatile("" : "+v"(fre), "+v"(fqe));
          E(acc, cur, wr, wc, fre, fqe, wid, fqe * 16 + fre); }
        if (!has_next) break;
#pragma unroll
        for (int a = 0; a < 2; ++a)
#pragma unroll
            for (int b = 0; b < 2; ++b)
#pragma unroll
                for (int m = 0; m < 4; ++m)
#pragma unroll
                    for (int n = 0; n < 2; ++n) acc[a][b][m][n] = (f32x4){0.f, 0.f, 0.f, 0.f};
        cur = nxt; cA0 = nA0; cA1 = nA1; cB0 = nB0; cB1 = nB1; ++ui;
        if (wr == 1) PG8_BAR;
    }
    PG8_WAIT_V(0);
    PG8_BAR;
#undef PG8_SA
#undef PG8_SB
#undef PG8_STAGE
#undef PG8_LDA
#undef PG8_LDB
#undef PG8_MMA
#undef PG8_WAIT_V
#undef PG8_WAIT_L
#undef PG8_BAR
#undef PG8_SCHED
}

struct EpiF32 {
    float* O; int ldc;
    __device__ __forceinline__ void operator()(f32x4 (&acc)[2][2][4][2], const Unit& u, int wr, int wc, int fr, int fq, int wid, int lane) const {
        const int row0 = u.pm * BM + wr * 64 + fr, col0 = u.pn * BM + wc * 32 + 4 * fq;
#pragma unroll
        for (int ai = 0; ai < 2; ++ai)
#pragma unroll
            for (int m = 0; m < 4; ++m) { float* rp = O + (size_t)(row0 + ai * HALF + m * 16) * ldc + col0;
#pragma unroll
                for (int bj = 0; bj < 2; ++bj)
#pragma unroll
                    for (int n = 0; n < 2; ++n) *(f32x4*)(rp + bj * HALF + n * 16) = acc[ai][bj][m][n]; }
    }
};

struct EpiLruIn {
    bf16_t* XB; bf16_t* SG;
    __device__ __forceinline__ void operator()(f32x4 (&acc)[2][2][4][2], const Unit& u, int wr, int wc, int fr, int fq, int wid, int lane) const {
        const int row0 = u.pm * BM + wr * 64 + fr; const bool gate = u.pn >= 8;
        bf16_t* base = gate ? SG : XB; const int col0 = (gate ? u.pn - 8 : u.pn) * BM + wc * 32 + 8 * fq;
#pragma unroll
        for (int ai = 0; ai < 2; ++ai)
#pragma unroll
            for (int m = 0; m < 4; ++m) { bf16_t* rp = base + (size_t)(row0 + ai * HALF + m * 16) * DM + col0;
#pragma unroll
                for (int bj = 0; bj < 2; ++bj) { f32x4 v0 = acc[ai][bj][m][0], v1 = acc[ai][bj][m][1];
                    if (gate) {
#pragma unroll
                        for (int j = 0; j < 4; ++j) { v0[j] = siluf_(v0[j]); v1[j] = siluf_(v1[j]); } }
                    u32x4 w; w.x = cvt_pk_bf16(v0[0], v0[1]); w.y = cvt_pk_bf16(v0[2], v0[3]); w.z = cvt_pk_bf16(v1[0], v1[1]); w.w = cvt_pk_bf16(v1[2], v1[3]);
                    *(u32x4*)(rp + bj * HALF) = w; } }
    }
};

struct EpiQKVG {
    bf16_t* Q; bf16_t* KP; bf16_t* VP; bf16_t* KS; bf16_t* VS; bf16_t* SG; float* ock; float* ocv;
    const float* qn; const float* kn; const float* rope; LAS float* P;
    __device__ __forceinline__ void operator()(f32x4 (&acc)[2][2][4][2], const Unit& u, int wr, int wc, int fr, int fq, int wid, int lane) const {
        const int pn = u.pn, pm = u.pm; const bool sample = pm >= 16;
        const int rl0 = wr * 64 + fr;
        const int sb = (pm - 16) >> 2, st0 = ((pm - 16) & 3) * 256;
        if (pn < 10) {
#pragma unroll
            for (int ai = 0; ai < 2; ++ai)
#pragma unroll
                for (int m = 0; m < 4; ++m)
#pragma unroll
                    for (int bj = 0; bj < 2; ++bj) { const f32x4 x0 = acc[ai][bj][m][0], x1 = acc[ai][bj][m][1];
                        float s = (x0[0] * x0[0] + x0[1] * x0[1]) + (x0[2] * x0[2] + x0[3] * x0[3]) + (x1[0] * x1[0] + x1[1] * x1[1]) + (x1[2] * x1[2] + x1[3] * x1[3]);
                        s += __shfl_xor(s, 16); s += __shfl_xor(s, 32);
                        if (fq == 0) P[(ai * HALF + rl0 + m * 16) * 8 + bj * 4 + wc] = s; }
            LDS_WAIT(); __builtin_amdgcn_s_barrier(); asm volatile("" ::: "memory");
            const bool isq = pn < 8; const float* nw = isq ? qn : kn;
            const int dlo = 64 * (wc >> 1) + 16 * (wc & 1) + 4 * fq;
            const f32x4 wlo = *(const f32x4*)(nw + dlo), whi = *(const f32x4*)(nw + dlo + 32);
#pragma unroll
            for (int ai = 0; ai < 2; ++ai)
#pragma unroll
                for (int m = 0; m < 4; ++m) { const int rl = ai * HALF + rl0 + m * 16; const int row = pm * BM + rl;
                    f32x4 cs0 = {1.f, 0.f, 1.f, 0.f}, cs1 = {1.f, 0.f, 1.f, 0.f};
                    if (sample) { const int t = st0 + rl; const int pos = (wc >> 1) ? (t & 63) : (t >> 6); const float* rp = rope + (pos * 32 + 16 * (wc & 1) + 4 * fq) * 2; cs0 = *(const f32x4*)rp; cs1 = *(const f32x4*)(rp + 4); }
                    const float cc[4] = {cs0[0], cs0[2], cs1[0], cs1[2]}, sn[4] = {cs0[1], cs0[3], cs1[1], cs1[3]};
#pragma unroll
                    for (int bj = 0; bj < 2; ++bj) { const f32x4 p4 = *(const LAS f32x4*)(P + rl * 8 + bj * 4);
                        const float rstd = rsqrtf(((p4[0] + p4[1]) + (p4[2] + p4[3])) * (1.0f / 128.0f) + EPS);
                        f32x4 lo, hi;
#pragma unroll
                        for (int j = 0; j < 4; ++j) { const float a = acc[ai][bj][m][0][j] * rstd * wlo[j], b = acc[ai][bj][m][1][j] * rstd * whi[j]; lo[j] = a * cc[j] - b * sn[j]; hi[j] = b * cc[j] + a * sn[j]; }
                        u32x2 wl, wh; wl.x = cvt_pk_bf16(lo[0], lo[1]); wl.y = cvt_pk_bf16(lo[2], lo[3]); wh.x = cvt_pk_bf16(hi[0], hi[1]); wh.y = cvt_pk_bf16(hi[2], hi[3]);
                        if (isq) { bf16_t* d = Q + (size_t)row * DM + (2 * pn + bj) * 128 + dlo; *(u32x2*)d = wl; *(u32x2*)(d + 32) = wh; }
                        else { const int kvh = 2 * (pn - 8) + bj;
                            if (!sample) { bf16_t* d = KP + (size_t)row * KVW + kvh * 128 + dlo; *(u32x2*)d = wl; *(u32x2*)(d + 32) = wh;
                                float* o = ock + (size_t)row * KVW + kvh * 128 + dlo; *(f32x4*)o = lo; *(f32x4*)(o + 32) = hi; }
                            else { bf16_t* d = KS + ((size_t)sb * KSROWS + PAST + st0 + rl) * KVW + kvh * 128 + dlo; *(u32x2*)d = wl; *(u32x2*)(d + 32) = wh; } } }
                    asm volatile("" ::: "memory"); }
        } else if (pn < 12) {
#pragma unroll
            for (int ai = 0; ai < 2; ++ai)
#pragma unroll
                for (int m = 0; m < 4; ++m) { const int rl = ai * HALF + rl0 + m * 16; const int row = pm * BM + rl;
#pragma unroll
                    for (int bj = 0; bj < 2; ++bj) { const int col = (2 * (pn - 10) + bj) * 128 + wc * 32 + 8 * fq; const f32x4 v0 = acc[ai][bj][m][0], v1 = acc[ai][bj][m][1];
                        u32x4 w; w.x = cvt_pk_bf16(v0[0], v0[1]); w.y = cvt_pk_bf16(v0[2], v0[3]); w.z = cvt_pk_bf16(v1[0], v1[1]); w.w = cvt_pk_bf16(v1[2], v1[3]);
                        if (!sample) { *(u32x4*)(VP + (size_t)row * KVW + col) = w; float* o = ocv + (size_t)row * KVW + col; *(f32x4*)o = v0; *(f32x4*)(o + 4) = v1; }
                        else *(u32x4*)(VS + ((size_t)sb * KSROWS + PAST + st0 + rl) * KVW + col) = w; } }
        } else {
#pragma unroll
            for (int ai = 0; ai < 2; ++ai)
#pragma unroll
                for (int m = 0; m < 4; ++m) { const int row = pm * BM + ai * HALF + rl0 + m * 16;
#pragma unroll
                    for (int bj = 0; bj < 2; ++bj) { const int col = (pn - 12) * BM + bj * HALF + wc * 32 + 8 * fq; f32x4 v0 = acc[ai][bj][m][0], v1 = acc[ai][bj][m][1];
#pragma unroll
                        for (int j = 0; j < 4; ++j) { v0[j] = siluf_(v0[j]); v1[j] = siluf_(v1[j]); }
                        u32x4 w; w.x = cvt_pk_bf16(v0[0], v0[1]); w.y = cvt_pk_bf16(v0[2], v0[3]); w.z = cvt_pk_bf16(v1[0], v1[1]); w.w = cvt_pk_bf16(v1[2], v1[3]);
                        *(u32x4*)(SG + (size_t)row * DM + col) = w; } }
        }
    }
};

template <int CTRL> __device__ __forceinline__ float dppf(float oldv, float src) { return __int_as_float(__builtin_amdgcn_update_dpp(__float_as_int(oldv), __float_as_int(src), CTRL, 0xF, 0xF, false)); }
template <int Q> __device__ __forceinline__ void row_scan(float& A, float& B) {
#define RS_STEP(D) { const float Ap = dppf<(Q == 0 ? 0x110 : 0x100) + D>(1.0f, A), Bp = dppf<(Q == 0 ? 0x110 : 0x100) + D>(0.0f, B); B = A * Bp + B; A = A * Ap; }
    RS_STEP(1) RS_STEP(2) RS_STEP(4) RS_STEP(8)
#undef RS_STEP
}
struct ChainOrder {
    const char* XC; const char* WG; int vcu;
    __device__ bool next(int i, Unit& u) const {
        if (i >= 8) return false;
        int b, slab, s, ns, base, L; bool prompt;
        if (vcu < 128) { prompt = false; b = vcu >> 5; slab = vcu & 31; s = i; ns = 8; L = SEQS; base = NPR + b * SEQS; }
        else { prompt = true; const int c = 4 * (vcu - 128) + (i >> 1); b = c >> 5; slab = c & 31; s = i & 1; ns = 2; L = SEQP; base = b * SEQP; }
        u.pm = 0; u.pn = slab; u.s = s; u.ns = ns; u.rowf = base + 128 * s; u.rowb = base + L - 128 * (s + 1); u.bidx = b; u.flags = prompt ? 1 : 0;
        const int h = slab >> 2;
        u.a0 = XC + ((size_t)u.rowf * DM + h * 256) * 2; u.a1 = XC + ((size_t)u.rowb * DM + h * 256) * 2;
        u.b0 = WG + (size_t)slab * 256 * 256 * 2; u.b1 = u.b0 + (size_t)128 * 256 * 2;
        return true;
    }
};
struct EpiGateScan {
    const bf16_t* XC; const bf16_t* SG; float* PART; bf16_t* YG; float* ostate;
    const float* ba; const float* bx; const float* lam; const float* st_in;
    LAS float* X;
    LAS float* H;
    template <int Q> __device__ __forceinline__ void quadrant(f32x4 (&G)[4][2], const Unit& u, int wr, int wc, int fr, int fq, int lane, float (&cin)[4]) const {
        const int chl0 = 16 * wc + 4 * fq, ch0 = 64 * u.pn + chl0;
        const f32x4 ba4 = *(const f32x4*)(ba + Q * DM + ch0), bx4 = *(const f32x4*)(bx + Q * DM + ch0), lm4 = *(const f32x4*)(lam + Q * DM + ch0);
        float c8[4];
#pragma unroll
        for (int j = 0; j < 4; ++j) c8[j] = -8.0f * log1pf(__expf(-lm4[j]));
        const int rowbase = (Q == 0 ? u.rowf : u.rowb) + 64 * wr + fr;
#pragma unroll
        for (int m = 0; m < 4; ++m) { const u32x2 xw = *(const u32x2*)(XC + (size_t)(rowbase + 16 * m) * DM + ch0);
            const float xv[4] = {bf_lo(xw.x), bf_hi(xw.x), bf_lo(xw.y), bf_hi(xw.y)};
#pragma unroll
            for (int j = 0; j < 4; ++j) { const float r = sigmoidf_(G[m][0][j] + ba4[j]), ig = sigmoidf_(G[m][1][j] + bx4[j]);
                const float la = c8[j] * r, a = __expf(la), mult = sqrtf(-expm1f(2.0f * la));
                float A = a, B = mult * ig * xv[j];
                row_scan<Q>(A, B);
                G[m][0][j] = A; G[m][1][j] = B; } }
        const int srcl = (lane & 48) | (Q == 0 ? 15 : 0);
        float Wa[4] = {1.f, 1.f, 1.f, 1.f}, Wb[4] = {0.f, 0.f, 0.f, 0.f};
#pragma unroll
        for (int mm = 0; mm < 4; ++mm) { const int m = Q == 0 ? mm : 3 - mm;
#pragma unroll
            for (int j = 0; j < 4; ++j) { const float Ta = __shfl(G[m][0][j], srcl), Tb = __shfl(G[m][1][j], srcl); Wb[j] = Ta * Wb[j] + Tb; Wa[j] = Ta * Wa[j]; } }
        if (fr == 0) {
#pragma unroll
            for (int j = 0; j < 4; ++j) { X[((Q * 2 + wr) * 64 + chl0 + j) * 2 + 0] = Wa[j]; X[((Q * 2 + wr) * 64 + chl0 + j) * 2 + 1] = Wb[j]; }
            if (u.s == 0 && wr == 0) {
#pragma unroll
                for (int j = 0; j < 4; ++j) H[Q * 64 + chl0 + j] = (u.flags & 1) ? 0.f : st_in[(size_t)(u.bidx * 2 + Q) * DM + ch0 + j]; }
        }
    }
    template <int Q> __device__ __forceinline__ void finish(f32x4 (&G)[4][2], const Unit& u, int wr, int wc, int fr, int fq, int lane, float (&c)[4]) const {
        const int chl0 = 16 * wc + 4 * fq, ch0 = 64 * u.pn + chl0;
        const int srcl = (lane & 48) | (Q == 0 ? 15 : 0);
        const bool second = (Q == 0) ? (wr == 1) : (wr == 0);
#pragma unroll
        for (int j = 0; j < 4; ++j) { float h = H[Q * 64 + chl0 + j];
            if (second) { const float xa = X[((Q * 2 + (wr ^ 1)) * 64 + chl0 + j) * 2 + 0], xb = X[((Q * 2 + (wr ^ 1)) * 64 + chl0 + j) * 2 + 1]; h = xa * h + xb; }
            c[j] = h; }
#pragma unroll
        for (int mm = 0; mm < 4; ++mm) { const int m = Q == 0 ? mm : 3 - mm;
#pragma unroll
            for (int j = 0; j < 4; ++j) { const float h = G[m][0][j] * c[j] + G[m][1][j]; G[m][1][j] = h; c[j] = __shfl(h, srcl); } }
    }
    template <int Q> __device__ __forceinline__ void output(f32x4 (&G)[4][2], const Unit& u, int wr, int wc, int fr, int fq, int lane, const float (&c)[4]) const {
        const int chl0 = 16 * wc + 4 * fq, ch0 = 64 * u.pn + chl0;
        const int rowbase = (Q == 0 ? u.rowf : u.rowb) + 64 * wr + fr;
        const bool second = (Q == 0) ? (wr == 1) : (wr == 0);
        if (second && fr == 0) {
#pragma unroll
            for (int j = 0; j < 4; ++j) H[Q * 64 + chl0 + j] = c[j]; }
        const bool first_visit = (2 * u.s < u.ns);
#pragma unroll
        for (int m = 0; m < 4; ++m) { const size_t off = (size_t)(rowbase + 16 * m) * DM + ch0; const f32x4 h = G[m][1];
            if (first_visit) *(f32x4*)(PART + off) = h;
            else { const f32x4 p = *(const f32x4*)(PART + off); const u32x2 sw = *(const u32x2*)(SG + off);
                u32x2 w; w.x = cvt_pk_bf16((h[0] + p[0]) * bf_lo(sw.x), (h[1] + p[1]) * bf_hi(sw.x)); w.y = cvt_pk_bf16((h[2] + p[2]) * bf_lo(sw.y), (h[3] + p[3]) * bf_hi(sw.y));
                *(u32x2*)(YG + off) = w; } }
        if ((u.flags & 1) && u.s == u.ns - 1) {
            if (Q == 0 && wr == 1 && fr == 15) *(f32x4*)(ostate + (size_t)(u.bidx * 2 + 0) * DM + ch0) = G[3][1];
            if (Q == 1 && wr == 0 && fr == 0) *(f32x4*)(ostate + (size_t)(u.bidx * 2 + 1) * DM + ch0) = G[0][1];
        }
    }
    __device__ __forceinline__ void operator()(f32x4 (&acc)[2][2][4][2], const Unit& u, int wr, int wc, int fr, int fq, int wid, int lane) const {
        float c0[4], c1[4];
        quadrant<0>(acc[0][0], u, wr, wc, fr, fq, lane, c0);
        quadrant<1>(acc[1][1], u, wr, wc, fr, fq, lane, c1);
        LDS_WAIT(); __builtin_amdgcn_s_barrier(); asm volatile("" ::: "memory");
        finish<0>(acc[0][0], u, wr, wc, fr, fq, lane, c0);
        finish<1>(acc[1][1], u, wr, wc, fr, fq, lane, c1);
        LDS_WAIT(); __builtin_amdgcn_s_barrier(); asm volatile("" ::: "memory");
        output<0>(acc[0][0], u, wr, wc, fr, fq, lane, c0);
        output<1>(acc[1][1], u, wr, wc, fr, fq, lane, c1);
    }
};
}

namespace attn {
constexpr int D = 128, NW = 8, QBLK = 32, KVBLK = 64;
constexpr float SCALE = 0.088388347648318440f;
constexpr float THR = 8.f;
constexpr int LDQ = DM, LDK = KVW;
constexpr int SHM_V = KVBLK * D * 2, SHM_K = KVBLK * D * 2, SHM_ATTN = 2 * SHM_V + 2 * SHM_K + NW * 64 * 4;
#define KSWZ(row, colB) ((row) * 256 + ((colB) ^ (((row) & 7) << 4)))
#define SBAR() __builtin_amdgcn_sched_barrier(0)
__device__ __forceinline__ int crow(int r, int hi) { return (r & 3) + 8 * (r >> 2) + 4 * hi; }
__device__ __forceinline__ void partialSM(f32x16& p0, f32x16& p1, float& m_reg, float& mn, float& alpha) {
  constexpr float C = SCALE * 1.4426950408889634f;
  float pmax = p0[0];
#pragma unroll
  for (int r = 1; r < 16; ++r) pmax = fmaxf(pmax, p0[r]);
#pragma unroll
  for (int r = 0; r < 16; ++r) pmax = fmaxf(pmax, p1[r]);
  { auto rr = __builtin_amdgcn_permlane32_swap(__float_as_uint(pmax), __float_as_uint(pmax), false, false);
    pmax = fmaxf(__uint_as_float(rr[0]), __uint_as_float(rr[1])); }
  if (__builtin_expect(__all(pmax - m_reg <= THR / SCALE), 1)) { mn = m_reg; alpha = 1.f; }
  else { mn = fmaxf(m_reg, pmax); alpha = __builtin_amdgcn_exp2f((m_reg - mn) * C); m_reg = mn; }
  float mnC = -mn * C;
#pragma unroll
  for (int r = 0; r < 16; ++r) p0[r] = fmaf(p0[r], C, mnC);
#pragma unroll
  for (int r = 0; r < 16; ++r) p1[r] = fmaf(p1[r], C, mnC);
#pragma unroll
  for (int r = 0; r < 16; ++r) p0[r] = __builtin_amdgcn_exp2f(p0[r]);
}
__device__ __forceinline__ void finishSM(f32x16& p0, f32x16& p1, float alpha, float& l_reg, bf16x8& pa0, bf16x8& pa1, bf16x8& pa2, bf16x8& pa3) {
#pragma unroll
  for (int r = 0; r < 16; ++r) p1[r] = __builtin_amdgcn_exp2f(p1[r]);
  float ps = 0;
#pragma unroll
  for (int r = 0; r < 16; ++r) ps += p0[r];
#pragma unroll
  for (int r = 0; r < 16; ++r) ps += p1[r];
  { auto rr = __builtin_amdgcn_permlane32_swap(__float_as_uint(ps), __float_as_uint(ps), false, false);
    ps = __uint_as_float(rr[0]) + __uint_as_float(rr[1]); }
  l_reg = l_reg * alpha + ps;
#define PK4(P, BASE, OUT) do { unsigned a0 = cvt_pk_bf16(P[BASE + 0], P[BASE + 1]), a1 = cvt_pk_bf16(P[BASE + 2], P[BASE + 3]);   \
    unsigned b0 = cvt_pk_bf16(P[BASE + 4], P[BASE + 5]), b1 = cvt_pk_bf16(P[BASE + 6], P[BASE + 7]);                              \
    auto r0 = __builtin_amdgcn_permlane32_swap(a0, b0, false, false); auto r1 = __builtin_amdgcn_permlane32_swap(a1, b1, false, false); \
    u32x4 w = {r0[0], r1[0], r0[1], r1[1]}; OUT = *reinterpret_cast<bf16x8*>(&w); } while (0)
  PK4(p0, 0, pa0); PK4(p0, 8, pa1); PK4(p1, 0, pa2); PK4(p1, 8, pa3);
#undef PK4
}
__device__ __forceinline__ void qkt(f32x16& p0, f32x16& p1, const bf16_t* Ks, const bf16x8* qr, int r32, int hi) {
  p0 = f32x16{}; p1 = f32x16{};
#pragma unroll
  for (int d0 = 0; d0 < 8; ++d0) { int cb = (d0 * 16 + hi * 8) * 2;
    bf16x8 b0 = *reinterpret_cast<const bf16x8*>((const char*)Ks + KSWZ(r32, cb));
    bf16x8 b1 = *reinterpret_cast<const bf16x8*>((const char*)Ks + KSWZ(32 + r32, cb));
    p0 = __builtin_amdgcn_mfma_f32_32x32x16_bf16(b0, qr[d0], p0, 0, 0, 0);
    p1 = __builtin_amdgcn_mfma_f32_32x32x16_bf16(b1, qr[d0], p1, 0, 0, 0); }
}
__device__ __forceinline__ int v_st(int k, int c) { const int kk = (k & ~0xC) | ((k & 4) << 1) | ((k & 8) >> 1); return ((kk >> 3) * 4 + (c >> 5)) * 512 + ((kk & 7) * 32 + (c & 31)) * 2; }
__device__ __forceinline__ int v_rd_base(int lane) { return ((lane & 3) << 3) | (((lane >> 2) & 3) << 6) | (((lane >> 4) & 1) << 5) | (((lane >> 5) & 1) << 8); }
constexpr int v_rd_off(int d0, int ks, int half) { return d0 * 512 + ks * 4096 + half * 2048; }
template <int OFF> __device__ __forceinline__ s16x4 tr_read(int vb) {
  s16x4 r; asm volatile("ds_read_b64_tr_b16 %0, %1 offset:%2" : "=&v"(r) : "v"(vb), "i"(OFF) : "memory"); return r;
}
template <int D0> __device__ __forceinline__ void pv_one(f32x16& od, int vb, bf16x8 pa0, bf16x8 pa1, bf16x8 pa2, bf16x8 pa3) {
  const s16x4 l0 = tr_read<v_rd_off(D0, 0, 0)>(vb), h0 = tr_read<v_rd_off(D0, 0, 1)>(vb), l1 = tr_read<v_rd_off(D0, 1, 0)>(vb), h1 = tr_read<v_rd_off(D0, 1, 1)>(vb);
  const s16x4 l2 = tr_read<v_rd_off(D0, 2, 0)>(vb), h2 = tr_read<v_rd_off(D0, 2, 1)>(vb), l3 = tr_read<v_rd_off(D0, 3, 0)>(vb), h3 = tr_read<v_rd_off(D0, 3, 1)>(vb);
  asm volatile("s_waitcnt lgkmcnt(0)" ::: "memory"); SBAR();
#define PK(L, H) (bf16x8){L[0], L[1], L[2], L[3], H[0], H[1], H[2], H[3]}
  od = __builtin_amdgcn_mfma_f32_32x32x16_bf16(pa0, PK(l0, h0), od, 0, 0, 0);
  od = __builtin_amdgcn_mfma_f32_32x32x16_bf16(pa1, PK(l1, h1), od, 0, 0, 0);
  od = __builtin_amdgcn_mfma_f32_32x32x16_bf16(pa2, PK(l2, h2), od, 0, 0, 0);
  od = __builtin_amdgcn_mfma_f32_32x32x16_bf16(pa3, PK(l3, h3), od, 0, 0, 0);
#undef PK
}
__device__ __forceinline__ void pv_d0(f32x16* o, int vb, bf16x8 pa0, bf16x8 pa1, bf16x8 pa2, bf16x8 pa3) {
  pv_one<0>(o[0], vb, pa0, pa1, pa2, pa3); pv_one<1>(o[1], vb, pa0, pa1, pa2, pa3); pv_one<2>(o[2], vb, pa0, pa1, pa2, pa3); pv_one<3>(o[3], vb, pa0, pa1, pa2, pa3);
}
__device__ __forceinline__ void attn_unit(const bf16_t* __restrict__ Qb, const bf16_t* __restrict__ Kh, const bf16_t* __restrict__ Vh,
                                          const bf16_t* __restrict__ Gb, bf16_t* __restrict__ Ob, int seq, char* lds) {
  const int tid = threadIdx.x, wid = __builtin_amdgcn_readfirstlane(tid >> 6), lane = tid & 63, r32 = lane & 31, hi = lane >> 5;
  bf16_t* V_lds = (bf16_t*)lds; bf16_t* K_lds = (bf16_t*)(lds + 2 * SHM_V);
  float* ws = (float*)(lds + 2 * SHM_V + 2 * SHM_K) + wid * 64; float* li_l = ws; float* al_l = ws + 32;
  float m_reg = -1e30f, l_reg = 0; f32x16 o[4] = {}; bf16x8 qr[8];
  const bf16_t* Qw = Qb + (long)(wid * QBLK + r32) * LDQ + hi * 8;
#pragma unroll
  for (int d0 = 0; d0 < 8; ++d0) qr[d0] = *reinterpret_cast<const bf16x8*>(Qw + d0 * 16);
  const int sr = tid >> 4, sc = (tid & 15) * 8, vst0 = v_st(sr, sc), vst1 = v_st(32 + sr, sc);
  const int vb0 = (int)(uintptr_t)V_lds + v_rd_base(lane);
  struct { bf16x8 vs0, vs1, ks0, ks1; } sr_[2];
#define SLOAD(i, k0) do { sr_[i].vs0 = *reinterpret_cast<const bf16x8*>(&Vh[(long)((k0) + sr) * LDK + sc]); sr_[i].vs1 = *reinterpret_cast<const bf16x8*>(&Vh[(long)((k0) + 32 + sr) * LDK + sc]); \
    sr_[i].ks0 = *reinterpret_cast<const bf16x8*>(&Kh[(long)((k0) + sr) * LDK + sc]); sr_[i].ks1 = *reinterpret_cast<const bf16x8*>(&Kh[(long)((k0) + 32 + sr) * LDK + sc]); } while (0)
#define SWRITE(b, i) do { *(bf16x8*)((char*)V_lds + (b) * SHM_V + vst0) = sr_[i].vs0;          \
    *(bf16x8*)((char*)V_lds + (b) * SHM_V + vst1) = sr_[i].vs1; int kc = sc * 2;               \
    *(bf16x8*)((char*)K_lds + (b) * SHM_K + KSWZ(sr, kc)) = sr_[i].ks0;                       \
    *(bf16x8*)((char*)K_lds + (b) * SHM_K + KSWZ(32 + sr, kc)) = sr_[i].ks1; } while (0)
#define SWAIT() asm volatile("s_waitcnt vmcnt(4)" ::: "memory")
#define RESC(a) do { if (__any((a) < 1.f)) { if (hi == 0) al_l[r32] = (a); asm volatile("s_waitcnt lgkmcnt(0)" ::: "memory"); \
    _Pragma("unroll") for (int d = 0; d < 4; ++d) _Pragma("unroll") for (int r = 0; r < 16; ++r) o[d][r] *= al_l[crow(r, hi)]; } } while (0)
  f32x16 pA0, pA1, pB0, pB1; float mnA, mnB, alA, alB; bf16x8 pa0, pa1, pa2, pa3; const int NT = seq / KVBLK;
  constexpr int SE = 0, SO = 1;
  SLOAD(SE, 0); asm volatile("s_waitcnt vmcnt(0)" ::: "memory"); SWRITE(0, SE); __syncthreads();
  qkt(pA0, pA1, K_lds, qr, r32, hi); partialSM(pA0, pA1, m_reg, mnA, alA);
  SLOAD(SO, KVBLK); if (2 < NT) SLOAD(SE, 2 * KVBLK);
  SWAIT(); SWRITE(1, SO); __syncthreads();
  for (int j = 1; j + 1 < NT; j += 2) {
    SBAR(); qkt(pB0, pB1, (bf16_t*)((char*)K_lds + SHM_K), qr, r32, hi);
    finishSM(pA0, pA1, alA, l_reg, pa0, pa1, pa2, pa3); SBAR();
    SLOAD(SO, (j + 2) * KVBLK); SBAR();
    pv_d0(o, vb0, pa0, pa1, pa2, pa3); partialSM(pB0, pB1, m_reg, mnB, alB);
    __syncthreads(); SWAIT(); SWRITE(0, SE);
    RESC(alB); __syncthreads();
    SBAR(); qkt(pA0, pA1, K_lds, qr, r32, hi);
    finishSM(pB0, pB1, alB, l_reg, pa0, pa1, pa2, pa3); SBAR();
    if (j + 3 < NT) SLOAD(SE, (j + 3) * KVBLK); SBAR();
    pv_d0(o, vb0 + (int)SHM_V, pa0, pa1, pa2, pa3); partialSM(pA0, pA1, m_reg, mnA, alA);
    __syncthreads(); SWAIT(); SWRITE(1, SO);
    RESC(alA); __syncthreads();
  }
  SBAR(); qkt(pB0, pB1, (bf16_t*)((char*)K_lds + SHM_K), qr, r32, hi);
  finishSM(pA0, pA1, alA, l_reg, pa0, pa1, pa2, pa3); SBAR();
  pv_d0(o, vb0, pa0, pa1, pa2, pa3); partialSM(pB0, pB1, m_reg, mnB, alB);
  __syncthreads(); RESC(alB);
  finishSM(pB0, pB1, alB, l_reg, pa0, pa1, pa2, pa3); SBAR();
  pv_d0(o, vb0 + (int)SHM_V, pa0, pa1, pa2, pa3);
#ifdef ATT_EPI0
  if (hi == 0) li_l[r32] = l_reg; asm volatile("s_waitcnt lgkmcnt(0)" ::: "memory");
  float rli[16];
#pragma unroll
  for (int r = 0; r < 16; ++r) rli[r] = __builtin_amdgcn_rcpf(li_l[crow(r, hi)]);
  bf16_t* Ow = Ob + (long)(wid * QBLK) * LDQ;
#pragma unroll
  for (int r = 0; r < 16; ++r) { int orow = crow(r, hi);
    for (int d0 = 0; d0 < 4; ++d0) Ow[(long)orow * LDQ + d0 * 32 + r32] = (bf16_t)(cvt_pk_bf16(o[d0][r] * rli[r], 0.f) & 0xffff); }
  __syncthreads();
#else
  if (hi == 0) li_l[r32] = l_reg; asm volatile("s_waitcnt vmcnt(0) lgkmcnt(0)" ::: "memory");
  __syncthreads();
  float rli[16];
#pragma unroll
  for (int r = 0; r < 16; ++r) rli[r] = __builtin_amdgcn_rcpf(li_l[crow(r, hi)]);
  LAS unsigned char* stgw = (LAS unsigned char*)lds + wid * 8192;
  LAS bf16_t* stg = (LAS bf16_t*)(stgw + (4 * hi * 128 + r32) * 2);
#pragma unroll
  for (int r = 0; r < 16; ++r) {
#pragma unroll
    for (int d0 = 0; d0 < 4; ++d0) { const float v = o[d0][r] * rli[r]; stg[((r & 3) + 8 * (r >> 2)) * 128 + d0 * 32] = (bf16_t)(cvt_pk_bf16(v, v) & 0xffffu); } }
  asm volatile("s_waitcnt lgkmcnt(0)" ::: "memory");
  const bf16_t* Gw = Gb + (long)(wid * QBLK) * LDQ + (lane >> 4) * LDQ + (lane & 15) * 8; bf16_t* Ow = Ob + (long)(wid * QBLK) * LDQ + (lane >> 4) * LDQ + (lane & 15) * 8;
  LAS unsigned char* rdp = stgw + (lane >> 4) * 256 + (lane & 15) * 16;
#pragma unroll
  for (int i = 0; i < 8; ++i) {
    const u32x4 ov = *(const LAS u32x4*)(rdp + i * 1024); const u32x4 gv = *(const u32x4*)(Gw + (long)(i * 4) * LDQ);
    u32x4 w; w.x = cvt_pk_bf16(bf_lo(ov.x) * bf_lo(gv.x), bf_hi(ov.x) * bf_hi(gv.x)); w.y = cvt_pk_bf16(bf_lo(ov.y) * bf_lo(gv.y), bf_hi(ov.y) * bf_hi(gv.y));
    w.z = cvt_pk_bf16(bf_lo(ov.z) * bf_lo(gv.z), bf_hi(ov.z) * bf_hi(gv.z)); w.w = cvt_pk_bf16(bf_lo(ov.w) * bf_lo(gv.w), bf_hi(ov.w) * bf_hi(gv.w));
    *(u32x4*)(Ow + (long)(i * 4) * LDQ) = w; }
  asm volatile("s_waitcnt lgkmcnt(0)" ::: "memory");
  __syncthreads();
#endif
#undef SLOAD
#undef SWRITE
#undef SWAIT
#undef RESC
}
#undef KSWZ
#undef SBAR
}

typedef GAS unsigned gu32;
#define RLX_AGENT __ATOMIC_RELAXED, __HIP_MEMORY_SCOPE_AGENT
#define XB_TMO      128
#define XB_XCNT(j)  (256  + 64 * (j))
#define XB_XSUB(j)  (1280 + 64 * (j))
#define XB_XGEN(j)  (2304 + 64 * (j))
#define XB_TOP      3328
#define XB_TOPGEN   3392
#define XCD_BAR_WORDS 3456
#define XB_SPIN_CAP (1u << 18)
__device__ __forceinline__ unsigned xb_ld(unsigned* p)              { return __hip_atomic_load(p, __ATOMIC_RELAXED, __HIP_MEMORY_SCOPE_AGENT); }
__device__ __forceinline__ unsigned xb_add(unsigned* p, unsigned v) { return __hip_atomic_fetch_add(p, v, __ATOMIC_RELAXED, __HIP_MEMORY_SCOPE_AGENT); }
__device__ __forceinline__ unsigned xb_xcc_id() { return (unsigned)__builtin_amdgcn_s_getreg((3 << 11) | 20) & 0xFu; }
#define XB_SPIN(cond, bar) do { unsigned _sp = 0; while (cond) { __builtin_amdgcn_s_sleep(1); \
    if ((++_sp & 255u) == 0u) { if (xb_ld(&(bar)[XB_TMO])) break; if (_sp > XB_SPIN_CAP) { atomicAdd(&(bar)[XB_TMO], 1u); break; } } } } while (0)
struct XcdBarrier { unsigned* bar; unsigned x; volatile LAS unsigned* st; };
__device__ __forceinline__ XcdBarrier xcd_barrier_post(unsigned* bar, volatile LAS unsigned* st) {
    XcdBarrier b; b.bar = bar; b.x = xb_xcc_id(); b.st = st;
    if (threadIdx.x == 0) (void)xb_add(&bar[XB_XCNT(b.x)], 1u);
    return b;
}
__device__ __forceinline__ void xcd_barrier_complete(unsigned* bar, unsigned x, unsigned& nloc, unsigned& nx) {
    const unsigned G = gridDim.x * gridDim.y * gridDim.z;
    unsigned sum, cnt, mine, sp = 0u;
    for (;;) {
        sum = 0u; cnt = 0u; mine = 0u;
#pragma unroll
        for (unsigned j = 0; j < 16; ++j) { const unsigned c = xb_ld(&bar[XB_XCNT(j)]); sum += c; cnt += (c > 0u) ? 1u : 0u; mine = (j == x) ? c : mine; }
        if (sum == G) break;
        __builtin_amdgcn_s_sleep(1);
        if ((++sp & 255u) == 0u) { if (xb_ld(&bar[XB_TMO])) break; if (sp > XB_SPIN_CAP) { atomicAdd(&bar[XB_TMO], 1u); break; } }
    }
    nloc = mine > 0u ? mine : 1u; nx = cnt > 0u ? cnt : 1u;
}
__device__ __forceinline__ void xcd_barrier(const XcdBarrier& b) {
    asm volatile("s_waitcnt vmcnt(0)" ::: "memory");
    __syncthreads();
    if (threadIdx.x == 0) {
        unsigned* bar = b.bar;
        __builtin_amdgcn_s_waitcnt(0);
        unsigned nloc = b.st[0], nx = b.st[1];
        if (nloc == 0u) { xcd_barrier_complete(bar, b.x, nloc, nx); b.st[0] = nloc; b.st[1] = nx; }
        const unsigned old = xb_add(&bar[XB_XSUB(b.x)], 1u);
        const unsigned gen = old / nloc;
        if (old + 1u == (gen + 1u) * nloc) {
            __builtin_amdgcn_fence(__ATOMIC_RELEASE, "agent");
            asm volatile("s_waitcnt vmcnt(0)" ::: "memory");
            const unsigned og = xb_add(&bar[XB_TOP], 1u);
            const unsigned tg = og / nx;
            if (og + 1u == (tg + 1u) * nx) xb_add(&bar[XB_TOPGEN], 1u);
            else XB_SPIN(xb_ld(&bar[XB_TOPGEN]) == tg, bar);
            __builtin_amdgcn_fence(__ATOMIC_ACQUIRE, "agent");
            xb_add(&bar[XB_XGEN(b.x)], 1u);
            asm volatile("s_waitcnt vmcnt(0)" ::: "memory");
        } else {
            XB_SPIN(xb_ld(&bar[XB_XGEN(b.x)]) == gen, bar);
            __builtin_amdgcn_fence(__ATOMIC_ACQUIRE, "agent");
            asm volatile("s_waitcnt vmcnt(0)" ::: "memory");
        }
    }
    __syncthreads();
}

constexpr int NWAVES = 8;
constexpr int N_PHASES = 11;
struct Args { const float* in[24]; float* out; unsigned char* ws; int ph_lo, ph_hi, li, pad; };
struct Frame { LAS unsigned char* lds; int tid, lane, wave, vcu, G; };

__device__ __forceinline__ float wave_sum(float v) {
#pragma unroll
    for (int o = 1; o < 64; o <<= 1) v += __shfl_xor(v, o);
    return v;
}
__device__ __forceinline__ int cond_of_row(int m) { return m < NPR ? 0 : 1 + ((m - NPR) >> 10); }

typedef __attribute__((address_space(4))) const unsigned char* kptr_t;
template <typename T> __device__ __forceinline__ T karg(int byte_off) { kptr_t k = (kptr_t)__builtin_amdgcn_kernarg_segment_ptr(); asm volatile("" : "+s"(k)); return *(const __attribute__((address_space(4))) T*)(k + byte_off); }
#define INP(i) karg<const float*>(8 * (i))

struct SrcMap { const float* base; int ld; };
__device__ __forceinline__ int perm8_col(int p) { const int g = p & ~31, l = p & 31; const int n = (l >> 4) & 1, fq = (l >> 2) & 3, j = l & 3; return g + 8 * fq + 4 * n + j; }
__device__ __forceinline__ int sigma_head_col(int p) { const int hb = p & ~127, l = p & 127; const int wc = l >> 5, n = (l >> 4) & 1, r = l & 15; return hb + 64 * (wc >> 1) + 16 * (wc & 1) + r + 32 * n; }
struct WSrc { const float* w1; const float* w2; const float* w3; const float* w4; const float* wga; const float* wgx; };
__device__ __forceinline__ SrcMap src_of(int mat, int p, const WSrc& a) {
    SrcMap s;
    if (mat == 0) { const int col = (p < 2560) ? sigma_head_col(p) : perm8_col(p); s.base = a.w1 + col; s.ld = N1; }
    else if (mat == 1) { s.base = a.w2 + p; s.ld = DM; }
    else if (mat == 2) { s.base = a.w3 + perm8_col(p); s.ld = N3; }
    else if (mat == 3) { s.base = a.w4 + p; s.ld = DM; }
    else { const int slab = p >> 8, l = p & 255; const int bj = l >> 7, wc = (l >> 5) & 3, n = (l >> 4) & 1, r = l & 15; const int h = slab >> 2, q = slab & 3;
        const float* w = n ? a.wgx : a.wga;
        s.base = w + ((size_t)(bj * 8 + h) * 256) * 256 + 64 * q + 16 * wc + r; s.ld = 256; }
    return s;
}
__device__ __forceinline__ void p0_transpose_item(const WSrc& a, int mat, int K, bf16_t* WT, LAS float* scr, int item, int lane) {
    const int nkb = K / 64, pb = item / nkb, kb = item % nkb, k0 = 64 * kb, p0 = 32 * pb;
    const SrcMap s = src_of(mat, p0 + (lane & 31), a);
    const float* src = s.base + (size_t)(k0 + (lane >> 5)) * s.ld;
#pragma unroll 8
    for (int i = 0; i < 32; ++i) scr[(2 * i + (lane >> 5)) * 33 + (lane & 31)] = src[(size_t)(2 * i) * s.ld];
    LDS_WAIT(); asm volatile("" ::: "memory");
    const int c = lane & 7;
#pragma unroll
    for (int j = 0; j < 4; ++j) { const int n = (lane >> 3) + 8 * j; const LAS float* t = scr + (8 * c) * 33 + n;
        u32x4 o; o.x = cvt_pk_bf16(t[0 * 33], t[1 * 33]); o.y = cvt_pk_bf16(t[2 * 33], t[3 * 33]); o.z = cvt_pk_bf16(t[4 * 33], t[5 * 33]); o.w = cvt_pk_bf16(t[6 * 33], t[7 * 33]);
        *(u32x4*)(WT + (size_t)(p0 + n) * K + k0 + 8 * c) = o; }
    LDS_WAIT(); asm volatile("" ::: "memory");
}

__global__ void __launch_bounds__(NWAVES * 64, 2) fwd_kernel(Args args) {
    extern __shared__ __attribute__((aligned(16))) unsigned char lds[];
    Frame F;
    F.lds = (LAS unsigned char*)lds;
    F.tid = threadIdx.x; F.lane = F.tid & 63; F.wave = __builtin_amdgcn_readfirstlane(F.tid >> 6);
    F.G = gridDim.x; { const int bx = blockIdx.x; F.vcu = (F.G % 8 == 0) ? (bx % 8) * (F.G / 8) + bx / 8 : bx; }
    unsigned char* ws = karg<unsigned char*>(200);
    const int arg_li = karg<int>(216);
    gu32* ctl = (gu32*)(ws + WS_CTL);
    volatile LAS unsigned* MISC = (volatile LAS unsigned*)(F.lds + MISC_OFF);
    for (int u = F.tid; u < 128; u += NWAVES * 64) ((LAS unsigned*)(F.lds + MISC_OFF))[u] = 0u;
    __syncthreads();
    constexpr bool ONE_PER_PHASE = (MK_N_LAUNCHES == N_PHASES);
    XcdBarrier bar; bar.bar = (unsigned*)(ctl + CW_BAR) + arg_li * XCD_BAR_WORDS; bar.x = 0; bar.st = nullptr;
    if (!ONE_PER_PHASE) bar = xcd_barrier_post((unsigned*)(ctl + CW_BAR) + arg_li * XCD_BAR_WORDS, MISC + 8);
    const int lo = karg<int>(208), hi = karg<int>(212);
#ifndef PHASE_MASK
#define PHASE_MASK 0x7ff
#endif
#define IN(k) (((PHASE_MASK >> (k)) & 1) && lo <= (k) && (k) < hi)
#define SEAM(k) do { if (IN(k) && IN((k) + 1)) { if (!ONE_PER_PHASE) xcd_barrier(bar); } } while (0)

    float* MOD = (float*)(ws + WS_MOD); float* ROPE = (float*)(ws + WS_ROPE);
    bf16_t* W1T = (bf16_t*)(ws + WS_W1T); bf16_t* W2T = (bf16_t*)(ws + WS_W2T); bf16_t* W3T = (bf16_t*)(ws + WS_W3T); bf16_t* WGT = (bf16_t*)(ws + WS_WGT); bf16_t* W4T = (bf16_t*)(ws + WS_W4T);
    bf16_t* XN = (bf16_t*)(ws + WS_XN); bf16_t* QB = (bf16_t*)(ws + WS_Q); bf16_t* XB = QB;
    bf16_t* KP = (bf16_t*)(ws + WS_KP); bf16_t* VP = (bf16_t*)(ws + WS_VP); bf16_t* KS = (bf16_t*)(ws + WS_KS); bf16_t* VS = (bf16_t*)(ws + WS_VS);
    bf16_t* SG = (bf16_t*)(ws + WS_SG); bf16_t* AO = (bf16_t*)(ws + WS_AO); bf16_t* YG = AO; float* MF = (float*)(ws + WS_MF); float* PART = MF; bf16_t* XC = (bf16_t*)(ws + WS_XC);
    float* Y = karg<float*>(192);
    float* OCK = Y + (size_t)MTOK * DM; float* OCV = OCK + (size_t)NPR * KVW; float* OST = OCV + (size_t)NPR * KVW;
    const int gw = F.vcu * NWAVES + F.wave, NGW = F.G * NWAVES;
    const int gt = blockIdx.x * (NWAVES * 64) + F.tid, NGT = F.G * NWAVES * 64;

    if (IN(0)) {
        LAS float* S = (LAS float*)(F.lds);
        const float* in_c = INP(2); const float* in_cctx = INP(6); const float* in_wmod = INP(7); const float* in_bmod = INP(8);
        LAS float* R = (LAS float*)(F.lds + 40960);
        for (int i = F.tid; i < 5 * DM; i += NWAVES * 64) { const int cnd = i >> 11, k = i & (DM - 1); const float v = cnd == 0 ? in_cctx[k] : in_c[(cnd - 1) * DM + k]; S[i] = siluf_(v); }
        __syncthreads();
        for (int it = blockIdx.x; it < 256; it += F.G) {
            const int l = it >> 7, n0 = 48 * (it & 127); const float* W = in_wmod + (size_t)l * DM * 6144;
            const int rsub = F.lane >> 4, c4 = F.lane & 15; const bool act = c4 < 12;
            f32x4 acc[5];
#pragma unroll
            for (int c = 0; c < 5; ++c) acc[c] = (f32x4){0.f, 0.f, 0.f, 0.f};
            const float* wp = W + (size_t)(256 * F.wave + rsub) * 6144 + n0 + 4 * (act ? c4 : 0);
#pragma unroll 8
            for (int i = 0; i < 64; ++i) { const int k = 256 * F.wave + 4 * i + rsub; const f32x4 w4 = *(const f32x4*)(wp + (size_t)(4 * i) * 6144);
#pragma unroll
                for (int c = 0; c < 5; ++c) acc[c] += w4 * S[c * DM + k]; }
#pragma unroll
            for (int c = 0; c < 5; ++c)
#pragma unroll
                for (int q = 0; q < 4; ++q) { float v = acc[c][q]; v += __shfl_xor(v, 16); v += __shfl_xor(v, 32); acc[c][q] = v; }
            if (F.lane < 12) {
#pragma unroll
                for (int c = 0; c < 5; ++c)
#pragma unroll
                    for (int q = 0; q < 4; ++q) R[(F.wave * 5 + c) * 48 + 4 * F.lane + q] = acc[c][q]; }
            __syncthreads();
            if (F.tid < 240) { const int c = F.tid / 48, n = F.tid % 48; float s = in_bmod[l * 6144 + n0 + n];
#pragma unroll
                for (int w = 0; w < 8; ++w) s += R[(w * 5 + c) * 48 + n];
                MOD[(size_t)(l * 5 + c) * 6144 + n0 + n] = s; }
            __syncthreads();
        }
        {
            LAS float* scr = (LAS float*)(F.lds + F.wave * 16384);
            const WSrc wsrc{INP(11), INP(14), INP(15), INP(23), INP(18), INP(20)};
            constexpr int I1 = (DM / 64) * (N1 / 32), I2 = (DM / 64) * (DM / 32), I3 = (DM / 64) * (N3 / 32), I4 = I2, IG = (256 / 64) * (8192 / 32);
            constexpr int NITEMS = I1 + I2 + I3 + I4 + IG;
            for (int it = gw; it < NITEMS; it += NGW) {
                int r = it;
                if (r < I1) { p0_transpose_item(wsrc, 0, DM, W1T, scr, r, F.lane); continue; } r -= I1;
                if (r < I2) { p0_transpose_item(wsrc, 1, DM, W2T, scr, r, F.lane); continue; } r -= I2;
                if (r < I3) { p0_transpose_item(wsrc, 2, DM, W3T, scr, r, F.lane); continue; } r -= I3;
                if (r < I4) { p0_transpose_item(wsrc, 3, DM, W4T, scr, r, F.lane); continue; } r -= I4;
                p0_transpose_item(wsrc, 4, 256, WGT, scr, r, F.lane);
            }
        }
        for (int i = gt; i < 64 * 32; i += NGT) { const int pos = i >> 5, fi = i & 31; const float inv = exp2f(-(float)fi * (13.287712379549449f / 32.0f)); float tr = (float)pos * inv * 0.15915494309189535f; tr -= floorf(tr);
            ROPE[2 * i] = __builtin_amdgcn_cosf(tr); ROPE[2 * i + 1] = __builtin_amdgcn_sinf(tr); }
        const float* in_ck = INP(3); const float* in_cv = INP(4);
        for (int i = gt; i < 2 * 4 * PAST * KVW / 8; i += NGT) { const int which = i >= (4 * PAST * KVW / 8); const int e = (which ? i - 4 * PAST * KVW / 8 : i) * 8; const int b = e / (PAST * KVW), r = e % (PAST * KVW);
            const float* src = (which ? in_cv : in_ck) + e; const f32x4 x0 = *(const f32x4*)src, x1 = *(const f32x4*)(src + 4);
            u32x4 w; w.x = cvt_pk_bf16(x0[0], x0[1]); w.y = cvt_pk_bf16(x0[2], x0[3]); w.z = cvt_pk_bf16(x1[0], x1[1]); w.w = cvt_pk_bf16(x1[2], x1[3]);
            *(u32x4*)((which ? VS : KS) + (size_t)b * KSROWS * KVW + r) = w; }
    }
    SEAM(0);

    if (IN(1)) {
        const float* in_xp = INP(0); const float* in_xs = INP(1); const float* in_gpre = INP(9);
        for (int m = gw; m < MTOK; m += NGW) {
            const float* xrow = m < NPR ? in_xp + (size_t)m * DM : in_xs + (size_t)(m - NPR) * DM;
            const float* md = MOD + (size_t)(0 * 5 + cond_of_row(m)) * 6144; const float* gp = in_gpre;
            f32x4 v[8]; float s = 0.f;
#pragma unroll
            for (int j = 0; j < 8; ++j) { v[j] = *((const f32x4*)xrow + F.lane + 64 * j); s += (v[j][0] * v[j][0] + v[j][1] * v[j][1]) + (v[j][2] * v[j][2] + v[j][3] * v[j][3]); }
            const float rstd = rsqrtf(wave_sum(s) * (1.0f / DM) + EPS);
#pragma unroll
            for (int j = 0; j < 8; ++j) { const int k = 4 * (F.lane + 64 * j); const f32x4 g = *(const f32x4*)(gp + k), sh = *(const f32x4*)(md + k), sc = *(const f32x4*)(md + DM + k);
                const f32x4 h = v[j] * rstd * g * (sc + 1.0f) + sh; u32x2 w; w.x = cvt_pk_bf16(h[0], h[1]); w.y = cvt_pk_bf16(h[2], h[3]);
                *(u32x2*)(XN + (size_t)m * DM + k) = w; }
        }
    }
    SEAM(1);

    if (IN(2)) {
        pg8::StaticOrder S; S.init(XN, W1T, MTOK, N1, DM, DM, F.G, (int)blockIdx.x);
        pg8::EpiQKVG E{QB, KP, VP, KS, VS, SG, OCK, OCV, INP(12), INP(13), ROPE, (LAS float*)(F.lds + EPI_OFF)};
        pg8::gemm_phase(F.lds, DM, DM, S, E);
    }
    SEAM(2);

    if (IN(3)) {
        for (int vv = 2 * F.vcu; vv < 512; vv += 2 * F.G) {
#pragma unroll 1
            for (int uu = 0; uu < 2; ++uu) {
                const int v = vv >> 1; const bool smp = (uu == 0);
                const int b = smp ? (v >> 6) : (v >> 4), h = smp ? ((v >> 2) & 15) : (v & 15);
                const size_t row0 = smp ? (size_t)NPR + b * SEQS + (v & 3) * 256 : (size_t)b * SEQP;
                const size_t kvoff = (smp ? (size_t)b * KSROWS * KVW : row0 * KVW) + (h >> 2) * 128;
                const size_t qoff = row0 * DM + h * 128;
                attn::attn_unit(QB + qoff, (smp ? KS : KP) + kvoff, (smp ? VS : VP) + kvoff, SG + qoff, AO + qoff, smp ? KSROWS : SEQP, (char*)lds);
            }
        }
    }
    SEAM(3);

    if (IN(4)) {
        pg8::StaticOrder S; S.init(AO, W2T, MTOK, DM, DM, DM, F.G, (int)blockIdx.x);
        pg8::EpiF32 E{MF, DM};
        pg8::gemm_phase(F.lds, DM, DM, S, E);
    }
    SEAM(4);

    if (IN(5)) {
        const float* in_xp = INP(0); const float* in_xs = INP(1); const float* in_gpre = INP(9); const float* in_gpost = INP(10);
        for (int m = gw; m < MTOK; m += NGW) {
            const float* xrow = m < NPR ? in_xp + (size_t)m * DM : in_xs + (size_t)(m - NPR) * DM;
            const int cnd = cond_of_row(m); const float* md0 = MOD + (size_t)(0 * 5 + cnd) * 6144; const float* md1 = MOD + (size_t)(1 * 5 + cnd) * 6144;
            const float* gpo = in_gpost; const float* gpr = in_gpre + DM;
            f32x4 v[8]; float s = 0.f;
#pragma unroll
            for (int j = 0; j < 8; ++j) { v[j] = *((const f32x4*)(MF + (size_t)m * DM) + F.lane + 64 * j); s += (v[j][0] * v[j][0] + v[j][1] * v[j][1]) + (v[j][2] * v[j][2] + v[j][3] * v[j][3]); }
            const float rstd = rsqrtf(wave_sum(s) * (1.0f / DM) + EPS); float s2 = 0.f;
#pragma unroll
            for (int j = 0; j < 8; ++j) { const int k = 4 * (F.lane + 64 * j); const f32x4 x = *(const f32x4*)(xrow + k), g = *(const f32x4*)(gpo + k), ga = *(const f32x4*)(md0 + 2 * DM + k);
                v[j] = x + ga * (v[j] * rstd * g); *(f32x4*)(Y + (size_t)m * DM + k) = v[j]; s2 += (v[j][0] * v[j][0] + v[j][1] * v[j][1]) + (v[j][2] * v[j][2] + v[j][3] * v[j][3]); }
            const float rstd2 = rsqrtf(wave_sum(s2) * (1.0f / DM) + EPS);
#pragma unroll
            for (int j = 0; j < 8; ++j) { const int k = 4 * (F.lane + 64 * j); const f32x4 g = *(const f32x4*)(gpr + k), sh = *(const f32x4*)(md1 + k), sc = *(const f32x4*)(md1 + DM + k);
                const f32x4 h = v[j] * rstd2 * g * (sc + 1.0f) + sh; u32x2 w; w.x = cvt_pk_bf16(h[0], h[1]); w.y = cvt_pk_bf16(h[2], h[3]);
                *(u32x2*)(XN + (size_t)m * DM + k) = w; }
        }
    }
    SEAM(5);

    if (IN(6)) {
        pg8::StaticOrder S; S.init(XN, W3T, MTOK, N3, DM, DM, F.G, (int)blockIdx.x);
        pg8::EpiLruIn E{XB, SG};
        pg8::gemm_phase(F.lds, DM, DM, S, E);
    }
    SEAM(6);

    if (IN(7)) {
        const float* cw = INP(16); const float* cb = INP(17);
        for (int idx = gt; idx < MTOK * (DM / 8); idx += NGT) {
            const int m = idx >> 8, ch0 = (idx & 255) * 8;
            const int t = m < NPR ? (m & (SEQP - 1)) : ((m - NPR) & (SEQS - 1)); const int L = m < NPR ? SEQP : SEQS;
            float acc[8];
            { const f32x4 b0 = *(const f32x4*)(cb + ch0), b1 = *(const f32x4*)(cb + ch0 + 4); acc[0] = b0[0]; acc[1] = b0[1]; acc[2] = b0[2]; acc[3] = b0[3]; acc[4] = b1[0]; acc[5] = b1[1]; acc[6] = b1[2]; acc[7] = b1[3]; }
#pragma unroll
            for (int j = 0; j < 4; ++j) { const int tt = t + j - 1; if (tt < 0 || tt >= L) continue;
                const u32x4 xv = *(const u32x4*)(XB + (size_t)(m + j - 1) * DM + ch0); const f32x4 w0 = *(const f32x4*)(cw + j * DM + ch0), w1 = *(const f32x4*)(cw + j * DM + ch0 + 4);
                acc[0] += bf_lo(xv.x) * w0[0]; acc[1] += bf_hi(xv.x) * w0[1]; acc[2] += bf_lo(xv.y) * w0[2]; acc[3] += bf_hi(xv.y) * w0[3];
                acc[4] += bf_lo(xv.z) * w1[0]; acc[5] += bf_hi(xv.z) * w1[1]; acc[6] += bf_lo(xv.w) * w1[2]; acc[7] += bf_hi(xv.w) * w1[3]; }
            u32x4 w; w.x = cvt_pk_bf16(acc[0], acc[1]); w.y = cvt_pk_bf16(acc[2], acc[3]); w.z = cvt_pk_bf16(acc[4], acc[5]); w.w = cvt_pk_bf16(acc[6], acc[7]);
            *(u32x4*)(XC + (size_t)m * DM + ch0) = w;
        }
    }
    SEAM(7);

    if (IN(8)) {
        if (F.G == 256) {
            pg8::ChainOrder S{(const char*)XC, (const char*)WGT, F.vcu};
            pg8::EpiGateScan E{XC, SG, PART, YG, OST, INP(19), INP(21), INP(22), INP(5), (LAS float*)(F.lds + EPI_OFF), (LAS float*)(F.lds + EPI_OFF + 4096)};
            pg8::gemm_phase(F.lds, 256, DM, S, E);
        }
    }
    SEAM(8);

    if (IN(9)) {
        pg8::StaticOrder S; S.init(YG, W4T, MTOK, DM, DM, DM, F.G, (int)blockIdx.x);
        pg8::EpiF32 E{MF, DM};
        pg8::gemm_phase(F.lds, DM, DM, S, E);
    }
    SEAM(9);

    if (IN(10)) {
        const float* in_gpost = INP(10);
        for (int m = gw; m < MTOK; m += NGW) {
            const int cnd = cond_of_row(m); const float* md1 = MOD + (size_t)(1 * 5 + cnd) * 6144; const float* gpo = in_gpost + DM;
            f32x4 v[8]; float s = 0.f;
#pragma unroll
            for (int j = 0; j < 8; ++j) { v[j] = *((const f32x4*)(MF + (size_t)m * DM) + F.lane + 64 * j); s += (v[j][0] * v[j][0] + v[j][1] * v[j][1]) + (v[j][2] * v[j][2] + v[j][3] * v[j][3]); }
            const float rstd = rsqrtf(wave_sum(s) * (1.0f / DM) + EPS);
#pragma unroll
            for (int j = 0; j < 8; ++j) { const int k = 4 * (F.lane + 64 * j); float* yp = Y + (size_t)m * DM + k; const f32x4 x = *(const f32x4*)yp, g = *(const f32x4*)(gpo + k), ga = *(const f32x4*)(md1 + 2 * DM + k);
                *(f32x4*)yp = x + ga * (v[j] * rstd * g); }
        }
    }
#undef IN
#undef SEAM
}

extern "C" void kernel_launch(void* const* d_in, const int* in_sizes, int n_in, void* d_out, int out_size, void* d_ws, size_t ws_size, hipStream_t stream) {
    static int grid = 0;
    if (grid == 0) {
        if (n_in != 24 || ws_size < WS_END || out_size != 21037056) { fprintf(stderr, "kernel_launch: unexpected shapes: n_in %d out %d ws %zu (need >= %zu)\n", n_in, out_size, ws_size, (size_t)WS_END); grid = -1; return; }
        int dev = 0, cus = 0, per_cu = 0;
        if (hipGetDevice(&dev) != hipSuccess || hipDeviceGetAttribute(&cus, hipDeviceAttributeMultiprocessorCount, dev) != hipSuccess) { fprintf(stderr, "kernel_launch: device query failed\n"); grid = -1; return; }
        if (hipFuncSetAttribute((const void*)fwd_kernel, hipFuncAttributeMaxDynamicSharedMemorySize, LDS_BYTES) != hipSuccess) { fprintf(stderr, "kernel_launch: hipFuncSetAttribute failed\n"); grid = -1; return; }
        if (hipOccupancyMaxActiveBlocksPerMultiprocessor(&per_cu, (const void*)fwd_kernel, NWAVES * 64, LDS_BYTES) != hipSuccess || per_cu < 1)
            fprintf(stderr, "kernel_launch: note: occupancy query reports %d workgroups per CU\n", per_cu);
        (void)hipGetLastError();
        grid = cus;
        if (grid != 256) fprintf(stderr, "kernel_launch: %d CUs; the LRU phase needs exactly 256 workgroups\n", grid);
    }
    if (grid < 0) return;
    if (hipMemsetAsync((char*)d_ws + WS_CTL, 0, CTL_ZERO_BYTES, stream) != hipSuccess) { fprintf(stderr, "kernel_launch: memset failed\n"); return; }
    Args a{};
    for (int i = 0; i < 24; ++i) a.in[i] = (const float*)d_in[i];
    a.out = (float*)d_out; a.ws = (unsigned char*)d_ws;
    constexpr int NL = MK_N_LAUNCHES;
    for (int li = 0; li < NL; ++li) {
        if (NL == N_PHASES) { a.ph_lo = li; a.ph_hi = li + 1; a.li = 0; }
        else { a.ph_lo = li * N_PHASES / NL; a.ph_hi = (li + 1) * N_PHASES / NL; a.li = li; }
        hipLaunchKernelGGL(fwd_kernel, dim3(grid), dim3(NWAVES * 64), LDS_BYTES, stream, a);
        const hipError_t le = hipPeekAtLastError();
        if (le != hipSuccess) { fprintf(stderr, "kernel_launch: launch %d failed: %s\n", li, hipGetErrorName(le)); break; }
    }
}
```
